# Optimizing an MI355X kernel written in HIP

```python
import jax, jax.numpy as jnp
from jax import lax
import numpy as np

D_MODEL = 1024
BATCH = 4
SEQ = 4096
DEPTH = 1

DSA_HEADS = 8
DSA_HEAD_DIM = 64
DSA_WIDTH = DSA_HEADS * DSA_HEAD_DIM
IDX_HEADS = 8
IDX_DIM = 64
TOPK_MAX = 256
Q_BLOCK = 128
ROPE_THETA = 10000.0
GDN_HEADS = 8
GDN_DK = 64
GDN_DV = 64
GDN_QK_WIDTH = GDN_HEADS * GDN_DK
GDN_V_WIDTH = GDN_HEADS * GDN_DV
CONV_WIDTH = 4
CONV_CH = 2 * GDN_QK_WIDTH + GDN_V_WIDTH
CHUNK = 64
N_GROUPS = 4
EXPERTS_PER_GROUP = 4
N_EXPERTS = N_GROUPS * EXPERTS_PER_GROUP
TOP_K_IN_GROUP = 2
D_EXPERT = 256
NORM_EPS = 1e-6

SPLIT_SIZES = (DSA_WIDTH, DSA_WIDTH, DSA_WIDTH, IDX_HEADS * IDX_DIM, IDX_DIM, IDX_HEADS,
               GDN_QK_WIDTH, GDN_QK_WIDTH, GDN_V_WIDTH, GDN_V_WIDTH, GDN_HEADS, GDN_HEADS,
               D_MODEL, D_MODEL)
D_IN = sum(SPLIT_SIZES)

kernel_name = "hybrid_dsa_gdn_hmoe_block"


def rms_norm(x, w):
    xf = x.astype(jnp.float32)
    y = xf * lax.rsqrt(jnp.mean(xf * xf, axis=-1, keepdims=True) + NORM_EPS)
    return (y * w.astype(jnp.float32)).astype(x.dtype)


def l2_normalize(x):
    xf = x.astype(jnp.float32)
    return xf * lax.rsqrt(jnp.sum(xf * xf, axis=-1, keepdims=True) + NORM_EPS)


def rope_tables(positions, dim):
    inv_freq = ROPE_THETA ** (-jnp.arange(0, dim, 2, dtype=jnp.float32) / dim)
    ang = positions.astype(jnp.float32)[..., None] * inv_freq
    return jnp.cos(ang), jnp.sin(ang)


def apply_rope(x, cos, sin):
    x1, x2 = jnp.split(x.astype(jnp.float32), 2, axis=-1)
    return jnp.concatenate([x1 * cos - x2 * sin, x2 * cos + x1 * sin], axis=-1).astype(x.dtype)


def dsa_attention(q, k, v, qi, ki, wi, n_keep):
    B, S, H, Dh = q.shape
    nb = S // Q_BLOCK
    key_pos = jnp.arange(S)
    idx_scale = (IDX_HEADS * IDX_DIM) ** -0.5
    att_scale = Dh ** -0.5
    ki32 = ki.astype(jnp.float32)
    b_idx = jnp.arange(B)[:, None, None]

    def to_blocks(t):
        return t.reshape((B, nb, Q_BLOCK) + t.shape[2:]).swapaxes(0, 1)

    def block(args):
        q_b, qi_b, wi_b, start = args
        qpos = start + jnp.arange(Q_BLOCK)
        causal = key_pos[None, :] <= qpos[:, None]
        logits = jnp.einsum('bqhd,bsd->bqhs', qi_b.astype(jnp.float32), ki32)
        score = jnp.einsum('bqh,bqhs->bqs', wi_b.astype(jnp.float32), jax.nn.relu(logits)) * idx_scale
        score = jnp.where(causal[None], score, -jnp.inf)
        _, sel = lax.top_k(score, n_keep)
        k_sel = k[b_idx, sel].astype(jnp.float32)
        v_sel = v[b_idx, sel].astype(jnp.float32)
        valid = sel <= qpos[None, :, None]
        s = jnp.einsum('bqhd,bqkhd->bhqk', q_b.astype(jnp.float32), k_sel) * att_scale
        s = jnp.where(valid[:, None], s, -jnp.inf)
        p = jax.nn.softmax(s, axis=-1)
        o = jnp.einsum('bhqk,bqkhd->bqhd', p, v_sel)
        return o.astype(q.dtype)

    starts = jnp.arange(nb) * Q_BLOCK
    out = lax.map(block, (to_blocks(q), to_blocks(qi), to_blocks(wi), starts))
    return out.swapaxes(0, 1).reshape(B, S, H, Dh)


def causal_conv_silu(x, w):
    S = x.shape[1]
    xp = jnp.pad(x, ((0, 0), (CONV_WIDTH - 1, 0), (0, 0)))
    y = sum(xp[:, j:j + S] * w[j] for j in range(CONV_WIDTH))
    return jax.nn.silu(y)


def gated_delta_chunked(q, k, v, g, beta):
    B, S, H, dk = q.shape
    dv = v.shape[-1]
    N = S // CHUNK

    def chunks(t):
        t = jnp.moveaxis(t, 2, 1)
        t = t.reshape(t.shape[:2] + (N, CHUNK) + t.shape[3:])
        return jnp.moveaxis(t, 2, 0)

    q = chunks(q) * dk ** -0.5
    k, v, g, beta = chunks(k), chunks(v), chunks(g), chunks(beta)
    gc = jnp.cumsum(g, axis=-1)
    tri_incl = jnp.tril(jnp.ones((CHUNK, CHUNK), bool))
    tri_strict = jnp.tril(jnp.ones((CHUNK, CHUNK), bool), -1)
    diff = gc[..., :, None] - gc[..., None, :]
    decay = jnp.where(tri_incl, jnp.exp(jnp.where(tri_incl, diff, 0.0)), 0.0)
    kb = k * beta[..., None]
    vb = v * beta[..., None]
    lmat = jnp.where(tri_strict, jnp.einsum('nbhid,nbhjd->nbhij', kb, k) * decay, 0.0)
    a_mat = jnp.eye(CHUNK, dtype=jnp.float32) + lmat
    rhs = jnp.concatenate([vb, kb * jnp.exp(gc)[..., None]], axis=-1)
    sol = lax.linalg.triangular_solve(a_mat, rhs, left_side=True, lower=True, unit_diagonal=True)
    u, w = sol[..., :dv], sol[..., dv:]
    a_qk = jnp.einsum('nbhid,nbhjd->nbhij', q, k) * decay
    q_g = q * jnp.exp(gc)[..., None]
    k_dec = k * jnp.exp(gc[..., -1:] - gc)[..., None]
    g_last = jnp.exp(gc[..., -1])

    def step(state, xs):
        u_i, w_i, qg_i, aqk_i, kd_i, gl_i = xs
        v_new = u_i - jnp.einsum('bhck,bhkv->bhcv', w_i, state)
        o = jnp.einsum('bhck,bhkv->bhcv', qg_i, state) + jnp.einsum('bhij,bhjv->bhiv', aqk_i, v_new)
        state = state * gl_i[..., None, None] + jnp.einsum('bhck,bhcv->bhkv', kd_i, v_new)
        return state, o

    s0 = jnp.zeros((B, H, dk, dv), jnp.float32)
    _, o = lax.scan(step, s0, (u, w, q_g, a_qk, k_dec, g_last))
    o = jnp.moveaxis(o, 0, 2).reshape(B, H, S, dv)
    return jnp.moveaxis(o, 1, 2)


def hybrid_mixer(h, rope_a, rope_i, w_in, conv_w, a_log, dt_bias, gdn_norm,
                 w_branch_dsa, w_branch_gdn, w_out):
    B, S, _ = h.shape
    offsets = np.cumsum(SPLIT_SIZES)[:-1].tolist()
    (dq, dk_, dv_, iq, ik, iw, gq, gk, gv, gz, gb, ga, gate_a, gate_b) = jnp.split(h @ w_in, offsets, axis=-1)

    cos_a, sin_a = rope_a
    cos_i, sin_i = rope_i
    q = apply_rope(dq.reshape(B, S, DSA_HEADS, DSA_HEAD_DIM), cos_a[:, :, None], sin_a[:, :, None])
    k = apply_rope(dk_.reshape(B, S, DSA_HEADS, DSA_HEAD_DIM), cos_a[:, :, None], sin_a[:, :, None])
    v = dv_.reshape(B, S, DSA_HEADS, DSA_HEAD_DIM)
    qi = apply_rope(iq.reshape(B, S, IDX_HEADS, IDX_DIM), cos_i[:, :, None], sin_i[:, :, None])
    ki = apply_rope(ik, cos_i, sin_i)
    n_keep = min(TOPK_MAX, S // 4)
    y_a = dsa_attention(q, k, v, qi, ki, iw, n_keep).reshape(B, S, DSA_WIDTH)
    y_a = y_a @ w_branch_dsa

    qkv = causal_conv_silu(jnp.concatenate([gq, gk, gv], axis=-1), conv_w)
    cq, ck, cv = jnp.split(qkv, [GDN_QK_WIDTH, 2 * GDN_QK_WIDTH], axis=-1)
    qg = l2_normalize(cq.reshape(B, S, GDN_HEADS, GDN_DK))
    kg = l2_normalize(ck.reshape(B, S, GDN_HEADS, GDN_DK))
    vg = cv.reshape(B, S, GDN_HEADS, GDN_DV).astype(jnp.float32)
    beta = jax.nn.sigmoid(gb.astype(jnp.float32))
    g = -jnp.exp(a_log.astype(jnp.float32)) * jax.nn.softplus(ga.astype(jnp.float32) + dt_bias.astype(jnp.float32))
    o = gated_delta_chunked(qg, kg, vg, g, beta)
    z = gz.reshape(B, S, GDN_HEADS, GDN_DV).astype(jnp.float32)
    o = rms_norm(o, gdn_norm) * jax.nn.silu(z)
    y_b = o.reshape(B, S, GDN_V_WIDTH).astype(h.dtype) @ w_branch_gdn

    merged = jax.nn.sigmoid(gate_a) * y_a + jax.nn.sigmoid(gate_b) * y_b
    return merged @ w_out


def hierarchical_moe(h, w_rg, b_rg, w_re, b_re, w_eg, w_eu, w_ed):
    B, S, D = h.shape
    t = h.reshape(-1, D)
    grp_prob = jax.nn.softmax((t @ w_rg).astype(jnp.float32) + b_rg.astype(jnp.float32), axis=-1)
    g_w, g_id = lax.top_k(grp_prob, 1)
    e_logits = ((t @ w_re).astype(jnp.float32) + b_re.astype(jnp.float32)).reshape(-1, N_GROUPS, EXPERTS_PER_GROUP)
    in_grp = jnp.take_along_axis(e_logits, g_id[:, :, None], axis=1)[:, 0]
    e_prob = jax.nn.softmax(in_grp, axis=-1)
    e_w, e_local = lax.top_k(e_prob, TOP_K_IN_GROUP)
    e_w = e_w / jnp.sum(e_w, axis=-1, keepdims=True)
    e_id = g_id * EXPERTS_PER_GROUP + e_local
    gates = e_w * g_w
    dense_gate = jnp.sum(jax.nn.one_hot(e_id, N_EXPERTS, dtype=jnp.float32) * gates[..., None], axis=1)
    hg = jnp.einsum('td,edf->tef', t, w_eg)
    hu = jnp.einsum('td,edf->tef', t, w_eu)
    act = jax.nn.silu(hg) * hu * dense_gate[..., None].astype(t.dtype)
    y = jnp.einsum('tef,efd->td', act, w_ed)
    return y.reshape(B, S, D)


def setup_inputs(seed: int = 0) -> dict:
    key = jax.random.key(seed)
    ks = jax.random.split(key, 26)
    f32 = jnp.float32
    L, D = DEPTH, D_MODEL

    def nrm(k, shape, scale):
        return jax.random.normal(k, shape, f32) * scale

    dt = jax.random.uniform(ks[9], (L, GDN_HEADS), f32, 0.001, 0.1)
    return {
        "x": nrm(ks[0], (BATCH, SEQ, D), 1.0),
        "c": nrm(ks[1], (BATCH, D), 1.0),
        "positions": jnp.tile(jnp.arange(SEQ, dtype=jnp.int32)[None], (BATCH, 1)),
        "w_ada": nrm(ks[2], (L, D, 6 * D), 0.25 * D ** -0.5),
        "b_ada": nrm(ks[3], (L, 6 * D), 0.01),
        "mix_norm_pre": 1.0 + nrm(ks[4], (L, D), 0.02),
        "mix_norm_post": 1.0 + nrm(ks[5], (L, D), 0.02),
        "w_in": nrm(ks[6], (L, D, D_IN), D ** -0.5),
        "conv_w": nrm(ks[7], (L, CONV_WIDTH, CONV_CH), CONV_WIDTH ** -0.5),
        "a_log": jnp.log(jax.random.uniform(ks[8], (L, GDN_HEADS), f32, 1.0, 16.0)),
        "dt_bias": dt + jnp.log(-jnp.expm1(-dt)),
        "gdn_norm": 1.0 + nrm(ks[10], (L, GDN_DV), 0.02),
        "w_branch_dsa": nrm(ks[11], (L, DSA_WIDTH, D), DSA_WIDTH ** -0.5),
        "w_branch_gdn": nrm(ks[12], (L, GDN_V_WIDTH, D), GDN_V_WIDTH ** -0.5),
        "w_out": nrm(ks[13], (L, D, D), D ** -0.5),
        "ffn_norm_pre": 1.0 + nrm(ks[14], (L, D), 0.02),
        "ffn_norm_post": 1.0 + nrm(ks[15], (L, D), 0.02),
        "w_router_group": nrm(ks[16], (L, D, N_GROUPS), D ** -0.5),
        "b_router_group": nrm(ks[17], (L, N_GROUPS), 0.01),
        "w_router_expert": nrm(ks[18], (L, D, N_EXPERTS), D ** -0.5),
        "b_router_expert": nrm(ks[19], (L, N_EXPERTS), 0.01),
        "w_expert_gate": nrm(ks[20], (L, N_EXPERTS, D, D_EXPERT), D ** -0.5),
        "w_expert_up": nrm(ks[21], (L, N_EXPERTS, D, D_EXPERT), D ** -0.5),
        "w_expert_down": nrm(ks[22], (L, N_EXPERTS, D_EXPERT, D), D_EXPERT ** -0.5),
    }


def reference(x, c, positions, w_ada, b_ada, mix_norm_pre, mix_norm_post, w_in, conv_w, a_log,
              dt_bias, gdn_norm, w_branch_dsa, w_branch_gdn, w_out, ffn_norm_pre, ffn_norm_post,
              w_router_group, b_router_group, w_router_expert, b_router_expert,
              w_expert_gate, w_expert_up, w_expert_down):
    rope_a = rope_tables(positions, DSA_HEAD_DIM)
    rope_i = rope_tables(positions, IDX_DIM)
    c_act = jax.nn.silu(c)
    for l in range(DEPTH):
        mod = (c_act @ w_ada[l] + b_ada[l])[:, None, :]
        shift1, scale1, gate1, shift2, scale2, gate2 = jnp.split(mod, 6, axis=-1)
        h = rms_norm(x, mix_norm_pre[l]) * (1.0 + scale1) + shift1
        y = hybrid_mixer(h, rope_a, rope_i, w_in[l], conv_w[l], a_log[l], dt_bias[l], gdn_norm[l],
                         w_branch_dsa[l], w_branch_gdn[l], w_out[l])
        x = x + gate1 * rms_norm(y, mix_norm_post[l])
        h = rms_norm(x, ffn_norm_pre[l]) * (1.0 + scale2) + shift2
        y = hierarchical_moe(h, w_router_group[l], b_router_group[l], w_router_expert[l],
                             b_router_expert[l], w_expert_gate[l], w_expert_up[l], w_expert_down[l])
        x = (x + gate2 * rms_norm(y, ffn_norm_post[l])).astype(x.dtype)
    return x
```

```cpp
#include <hip/hip_runtime.h>
#include <hip/hip_cooperative_groups.h>
#include <stdint.h>
namespace cg = cooperative_groups;

typedef _Float16 half_t;
typedef _Float16 h8 __attribute__((ext_vector_type(8)));
typedef _Float16 h4 __attribute__((ext_vector_type(4)));
typedef _Float16 h2 __attribute__((ext_vector_type(2)));
typedef float f4 __attribute__((ext_vector_type(4)));
typedef unsigned int u32;
typedef unsigned short u16;

#define NTHREADS 512
#define T_TOK 16384
#define SEQ 4096
#define DM 1024
#define NPAD 6400
#define LDS_BYTES (144 * 1024)

#define OFF_CTRL   0ull
#define OFF_MOD    4096ull
#define OFF_ROPEC  102400ull
#define OFF_ROPES  2199552ull
#define OFF_WTIN   4296704ull
#define OFF_WBD    17403904ull
#define OFF_WBG    18452480ull
#define OFF_WO     19501056ull
#define OFF_RA     21598208ull
#define OFF_QKV    55152640ull
#define OFF_RB     105484288ull
#define OFF_GQKV   175214592ull
#define OFF_GZ     225546240ull
#define OFF_BETA   242323456ull
#define OFF_G      242847744ull
#define OFF_GL     243372032ull
#define OFF_MASK   243380224ull
#define OFF_LIST   251768832ull
#define OFF_TOK    253341696ull
#define WS_NEEDED  253603840ull

struct Params {
    const float* x; const float* c; const int* pos; const float* w_ada; const float* b_ada;
    const float* norm_pre1; const float* norm_post1; const float* w_in; const float* conv_w;
    const float* a_log; const float* dt_bias; const float* gdn_norm; const float* w_bd; const float* w_bg;
    const float* w_out; const float* norm_pre2; const float* norm_post2; const float* w_rg; const float* b_rg;
    const float* w_re; const float* b_re; const float* w_eg; const float* w_eu; const float* w_ed;
    float* out; char* ws;
};

__device__ __forceinline__ float sigmoidf_(float x) { return 1.0f / (1.0f + __expf(-x)); }
__device__ __forceinline__ float siluf_(float x) { return x / (1.0f + __expf(-x)); }
__device__ __forceinline__ float wave_sum(float v) {
#pragma unroll
    for (int o = 32; o > 0; o >>= 1) v += __shfl_xor(v, o);
    return v;
}
__device__ __forceinline__ f4 mfma16(h8 a, h8 b, f4 c) { return __builtin_amdgcn_mfma_f32_16x16x32_f16(a, b, c, 0, 0, 0); }

__device__ __forceinline__ int swz(int r, int ch) { return r * 128 + ((ch ^ ((r >> 1) & 7)) << 4); }

template <int WM, int WN, class ALoad, class BLoad>
__device__ __forceinline__ void gemm_accum(char* lds, int K, const ALoad& al, const BLoad& bl, f4 (&acc)[4][4]) {
    constexpr int BM = 64 * WM, BN = 64 * WN;
    constexpr int A_BYTES = BM * 128, STAGE = (BM + BN) * 128;
    const int tid = threadIdx.x, wid = tid >> 6, lane = tid & 63;
    const int wm = wid / WN, wn = wid % WN, fr = lane & 15, fq = lane >> 4;
    const int lrow = tid >> 3, lch = tid & 7;
    uint4 ra[WM], rb[WN];
    const half_t* pa[WM]; const half_t* pb[WN];
#pragma unroll
    for (int p = 0; p < WM; ++p) pa[p] = al(lrow + 64 * p) + lch * 8;
#pragma unroll
    for (int p = 0; p < WN; ++p) pb[p] = bl(lrow + 64 * p) + lch * 8;
    const int nk = K >> 6;
    __syncthreads();
#pragma unroll
    for (int p = 0; p < WM; ++p) ra[p] = *(const uint4*)(pa[p]);
#pragma unroll
    for (int p = 0; p < WN; ++p) rb[p] = *(const uint4*)(pb[p]);
#pragma unroll
    for (int p = 0; p < WM; ++p) *(uint4*)(lds + swz(lrow + 64 * p, lch)) = ra[p];
#pragma unroll
    for (int p = 0; p < WN; ++p) *(uint4*)(lds + A_BYTES + swz(lrow + 64 * p, lch)) = rb[p];
    __syncthreads();
    for (int kt = 0; kt < nk; ++kt) {
        const bool more = (kt + 1 < nk);
        if (more) {
            const int k0 = (kt + 1) << 6;
#pragma unroll
            for (int p = 0; p < WM; ++p) ra[p] = *(const uint4*)(pa[p] + k0);
#pragma unroll
            for (int p = 0; p < WN; ++p) rb[p] = *(const uint4*)(pb[p] + k0);
        }
        const char* sa = lds + (kt & 1) * STAGE;
        const char* sb = sa + A_BYTES;
#pragma unroll
        for (int ks = 0; ks < 2; ++ks) {
            h8 af[4], bf[4];
#pragma unroll
            for (int m = 0; m < 4; ++m) af[m] = *(const h8*)(sa + swz(wm * 64 + m * 16 + fr, ks * 4 + fq));
#pragma unroll
            for (int n = 0; n < 4; ++n) bf[n] = *(const h8*)(sb + swz(wn * 64 + n * 16 + fr, ks * 4 + fq));
#pragma unroll
            for (int m = 0; m < 4; ++m)
#pragma unroll
                for (int n = 0; n < 4; ++n) acc[m][n] = mfma16(bf[n], af[m], acc[m][n]);
        }
        if (more) {
            char* da = lds + ((kt + 1) & 1) * STAGE;
#pragma unroll
            for (int p = 0; p < WM; ++p) *(uint4*)(da + swz(lrow + 64 * p, lch)) = ra[p];
#pragma unroll
            for (int p = 0; p < WN; ++p) *(uint4*)(da + A_BYTES + swz(lrow + 64 * p, lch)) = rb[p];
        }
        __syncthreads();
    }
}

__device__ __forceinline__ void zero_acc(f4 (&acc)[4][4]) {
#pragma unroll
    for (int m = 0; m < 4; ++m)
#pragma unroll
        for (int n = 0; n < 4; ++n) acc[m][n] = (f4){0.f, 0.f, 0.f, 0.f};
}

struct RowLoad {
    const half_t* base; long ld;
    __device__ __forceinline__ const half_t* operator()(int r) const { return base + (long)r * ld; }
};

__device__ __forceinline__ int win_src_col(int n) {
    if (n < 2120) return n;
    if (n < 2128) return 4168 + (n - 2120);
    if (n < 2136) return 4176 + (n - 2128);
    if (n < 2176) return -1;
    if (n < 3712) return 2120 + (n - 2176);
    if (n < 4224) return 3656 + (n - 3712);
    if (n < 6272) return 4184 + (n - 4224);
    return -1;
}

template <class ColF, class DstF>
__device__ __forceinline__ void transpose_tile(char* lds, const float* src, long ld, int k0, const ColF& colf, const DstF& dstf) {
    float* tile = (float*)lds;
    const int tid = threadIdx.x;
    __syncthreads();
#pragma unroll
    for (int j = 0; j < 8; ++j) {
        const int i = tid + 512 * j, kk = i >> 6, nn = i & 63;
        const int sc = colf(nn);
        tile[kk * 65 + nn] = sc >= 0 ? src[(long)(k0 + kk) * ld + sc] : 0.f;
    }
    __syncthreads();
    const int nn = tid >> 3, kc = (tid & 7) * 8;
    h8 v;
#pragma unroll
    for (int j = 0; j < 8; ++j) v[j] = (half_t)tile[(kc + j) * 65 + nn];
    *(h8*)(dstf(nn) + k0 + kc) = v;
}

__device__ __forceinline__ void expert_convert_unit(const Params& p, char* lds, int u) {
    half_t* weg = (half_t*)(p.ws + OFF_GQKV);
    half_t* wed = weg + 16l * 512 * 1024;
    if (u < 2048) {
        const int up = u >= 1024; const int v = u & 1023; const int e = v >> 6, r = v & 63, kt = r >> 2, nt = r & 3;
        const float* src = (up ? p.w_eu : p.w_eg) + (long)e * 1024 * 256;
        half_t* dst = weg + (long)e * 512 * 1024;
        transpose_tile(lds, src, 256, kt * 64, [&](int nn) { return nt * 64 + nn; },
                       [&](int nn) { const int f = nt * 64 + nn; return dst + (long)((f >> 5) * 64 + up * 32 + (f & 31)) * 1024; });
    } else {
        const int v = u - 2048; const int e = v >> 6, r = v & 63, kt = r >> 4, nt = r & 15;
        const float* src = p.w_ed + (long)e * 256 * 1024;
        half_t* dst = wed + (long)e * 1024 * 256;
        transpose_tile(lds, src, 1024, kt * 64, [&](int nn) { return nt * 64 + nn; },
                       [&](int nn) { return dst + (long)(nt * 64 + nn) * 256; });
    }
}

#define P0_MOD_UNITS 96
#define P0_ROPE_UNITS 256
#define P0_WIN_UNITS 1600
#define P0_WB_UNITS 128
#define P0_WO_UNITS 256
#define P0_UNITS (P0_MOD_UNITS + P0_ROPE_UNITS + P0_WIN_UNITS + 2 * P0_WB_UNITS + P0_WO_UNITS)

__device__ __forceinline__ void phase0(const Params& p, char* lds, int bid, int nb) {
    const int tid = threadIdx.x;
    if (bid == 0 && tid < 1024 / 4) ((u32*)(p.ws + OFF_CTRL))[tid] = 0u, ((u32*)(p.ws + OFF_CTRL))[tid + 256] = 0u, ((u32*)(p.ws + OFF_CTRL))[tid + 512] = 0u, ((u32*)(p.ws + OFF_CTRL))[tid + 768] = 0u;
    for (int u = bid; u < P0_UNITS; u += nb) {
        if (u < P0_MOD_UNITS) {
            float* cact = (float*)lds;
            float* red = cact + 4096;
            __syncthreads();
            for (int i = tid; i < 4096; i += NTHREADS) cact[i] = siluf_(p.c[i]);
            __syncthreads();
            const int col = tid & 63, kp = tid >> 6;
            float a0 = 0.f, a1 = 0.f, a2 = 0.f, a3 = 0.f;
            const float* wp = p.w_ada + (long)(kp * 128) * 6144 + u * 64 + col;
            for (int k = 0; k < 128; ++k) {
                const float w = wp[(long)k * 6144];
                const int kk = kp * 128 + k;
                a0 += cact[kk] * w; a1 += cact[1024 + kk] * w; a2 += cact[2048 + kk] * w; a3 += cact[3072 + kk] * w;
            }
            red[(kp * 4 + 0) * 64 + col] = a0; red[(kp * 4 + 1) * 64 + col] = a1; red[(kp * 4 + 2) * 64 + col] = a2; red[(kp * 4 + 3) * 64 + col] = a3;
            __syncthreads();
            if (tid < 256) {
                const int b = tid >> 6; float s = 0.f;
#pragma unroll
                for (int k = 0; k < 8; ++k) s += red[(k * 4 + b) * 64 + col];
                ((float*)(p.ws + OFF_MOD))[b * 6144 + u * 64 + col] = s + p.b_ada[u * 64 + col];
            }
        } else if (u < P0_MOD_UNITS + P0_ROPE_UNITS) {
            const int r = u - P0_MOD_UNITS;
            float* rc = (float*)(p.ws + OFF_ROPEC); float* rs = (float*)(p.ws + OFF_ROPES);
#pragma unroll
            for (int i = 0; i < 4; ++i) {
                const int idx = r * 2048 + tid + 512 * i, t = idx >> 5, fi = idx & 31;
                double inv = 1.0;
                for (int q = 0; q < fi; ++q) inv *= 0.74989420933245587;
                const double ang = (double)p.pos[t] * inv;
                const double kr = rint(ang * 0.15915494309189535);
                const float rf = (float)(ang - kr * 6.283185307179586);
                rc[idx] = cosf(rf); rs[idx] = sinf(rf);
            }
        } else {
            int v = u - (P0_MOD_UNITS + P0_ROPE_UNITS);
            if (v < P0_WIN_UNITS) {
                const int kt = v / 100, nt = v % 100;
                half_t* dst = (half_t*)(p.ws + OFF_WTIN);
                transpose_tile(lds, p.w_in, 6232, kt * 64, [&](int nn) { return win_src_col(nt * 64 + nn); },
                               [&](int nn) { return dst + (long)(nt * 64 + nn) * 1024; });
            } else if (v < P0_WIN_UNITS + 2 * P0_WB_UNITS) {
                v -= P0_WIN_UNITS; const int which = v >> 7; v &= 127; const int kt = v >> 4, nt = v & 15;
                half_t* dst = (half_t*)(p.ws + (which ? OFF_WBG : OFF_WBD));
                transpose_tile(lds, which ? p.w_bg : p.w_bd, 1024, kt * 64, [&](int nn) { return nt * 64 + nn; },
                               [&](int nn) { return dst + (long)(nt * 64 + nn) * 512; });
            } else {
                v -= P0_WIN_UNITS + 2 * P0_WB_UNITS; const int kt = v >> 4, nt = v & 15;
                half_t* dst = (half_t*)(p.ws + OFF_WO);
                transpose_tile(lds, p.w_out, 1024, kt * 64, [&](int nn) { return nt * 64 + nn; },
                               [&](int nn) { return dst + (long)(nt * 64 + nn) * 1024; });
            }
        }
    }
}

__device__ __forceinline__ void phase1(const Params& p, int bid, int nb) {
    const int wid = threadIdx.x >> 6, lane = threadIdx.x & 63;
    const float* mod = (const float*)(p.ws + OFF_MOD);
    half_t* hbuf = (half_t*)(p.ws + OFF_RA);
    for (int u = bid; u < T_TOK / 8; u += nb) {
        const int t = u * 8 + wid, b = t >> 12;
        const float* xr = p.x + (long)t * DM;
        f4 v[4]; float ss = 0.f;
#pragma unroll
        for (int i = 0; i < 4; ++i) { v[i] = *(const f4*)(xr + i * 256 + lane * 4); ss += v[i][0] * v[i][0] + v[i][1] * v[i][1] + v[i][2] * v[i][2] + v[i][3] * v[i][3]; }
        ss = wave_sum(ss);
        const float rstd = rsqrtf(ss * (1.0f / DM) + 1e-6f);
#pragma unroll
        for (int i = 0; i < 4; ++i) {
            const int c = i * 256 + lane * 4;
            const f4 w = *(const f4*)(p.norm_pre1 + c), sh = *(const f4*)(mod + b * 6144 + c), sc = *(const f4*)(mod + b * 6144 + 1024 + c);
            h4 o;
#pragma unroll
            for (int j = 0; j < 4; ++j) o[j] = (half_t)(v[i][j] * rstd * w[j] * (1.0f + sc[j]) + sh[j]);
            *(h4*)(hbuf + (long)t * DM + c) = o;
        }
    }
}

__device__ __forceinline__ void store_h4(half_t* p, float a, float b, float c, float d) {
    h4 o; o[0] = (half_t)a; o[1] = (half_t)b; o[2] = (half_t)c; o[3] = (half_t)d; *(h4*)p = o;
}

__device__ __forceinline__ void phase2(const Params& p, char* lds, int bid, int nb) {
    const int tid = threadIdx.x, wid = tid >> 6, lane = tid & 63, wm = wid >> 1, wn = wid & 1, fr = lane & 15, fq = lane >> 4;
    const half_t* hbuf = (const half_t*)(p.ws + OFF_RA);
    const half_t* wt = (const half_t*)(p.ws + OFF_WTIN);
    const float* rc = (const float*)(p.ws + OFF_ROPEC); const float* rs = (const float*)(p.ws + OFF_ROPES);
    half_t* qb = (half_t*)(p.ws + OFF_QKV); half_t* kb = qb + (long)T_TOK * 512; half_t* vT = kb + (long)T_TOK * 512;
    half_t* qi = (half_t*)(p.ws + OFF_RB + 50331648ull); half_t* ki = (half_t*)(p.ws + OFF_RB + 67108864ull); float* wi = (float*)(p.ws + OFF_RB + 69206016ull);
    half_t* gqkv = (half_t*)(p.ws + OFF_GQKV); half_t* gz = (half_t*)(p.ws + OFF_GZ);
    float* beta = (float*)(p.ws + OFF_BETA); float* gg = (float*)(p.ws + OFF_G);
    half_t* gates = (half_t*)p.out;
    const int NT = NPAD / 128, MT = T_TOK / 256;
    for (int u = bid; u < NT * MT; u += nb) {
        const int mt = u / NT, nt = u % NT;
        f4 acc[4][4]; zero_acc(acc);
        RowLoad al{hbuf + (long)mt * 256 * DM, DM}, bl{wt + (long)nt * 128 * DM, DM};
        gemm_accum<4, 2>(lds, DM, al, bl, acc);
        const int C0 = nt * 128 + wn * 64;
        const int R0 = mt * 256 + wm * 64;
        if (C0 < 512 || (C0 >= 512 && C0 < 1024) || (C0 >= 1536 && C0 < 2112)) {
            half_t* dst; int ld, cb;
            if (C0 < 512) { dst = qb; ld = 512; cb = C0; }
            else if (C0 < 1024) { dst = kb; ld = 512; cb = C0 - 512; }
            else if (C0 < 2048) { dst = qi; ld = 512; cb = C0 - 1536; }
            else { dst = ki; ld = 64; cb = 0; }
#pragma unroll
            for (int m = 0; m < 4; ++m) {
                const int t = R0 + m * 16 + fr;
#pragma unroll
                for (int n = 0; n < 2; ++n) {
                    const int d = n * 16 + 4 * fq;
                    const f4 cs = *(const f4*)(rc + t * 32 + d), sn = *(const f4*)(rs + t * 32 + d);
                    const f4 x1 = acc[m][n], x2 = acc[m][n + 2];
                    store_h4(dst + (long)t * ld + cb + d, x1[0] * cs[0] - x2[0] * sn[0], x1[1] * cs[1] - x2[1] * sn[1], x1[2] * cs[2] - x2[2] * sn[2], x1[3] * cs[3] - x2[3] * sn[3]);
                    store_h4(dst + (long)t * ld + cb + d + 32, x2[0] * cs[0] + x1[0] * sn[0], x2[1] * cs[1] + x1[1] * sn[1], x2[2] * cs[2] + x1[2] * sn[2], x2[3] * cs[3] + x1[3] * sn[3]);
                }
            }
        } else if (C0 < 1536) {
            const int hh = (C0 - 1024) >> 6;
#pragma unroll
            for (int m = 0; m < 4; ++m) {
                const int t = R0 + m * 16 + fr, b = t >> 12, s = t & 4095;
#pragma unroll
                for (int n = 0; n < 4; ++n)
#pragma unroll
                    for (int j = 0; j < 4; ++j) vT[((long)(b * 8 + hh) * 64 + n * 16 + 4 * fq + j) * SEQ + s] = (half_t)acc[m][n][j];
            }
        } else if (C0 == 2112) {
#pragma unroll
            for (int m = 0; m < 4; ++m) {
                const int t = R0 + m * 16 + fr;
#pragma unroll
                for (int n = 0; n < 2; ++n)
#pragma unroll
                    for (int j = 0; j < 4; ++j) {
                        const int col = n * 16 + 4 * fq + j; const float v = acc[m][n][j];
                        if (col < 8) wi[t * 8 + col] = v;
                        else if (col < 16) beta[t * 8 + col - 8] = sigmoidf_(v);
                        else if (col < 24) {
                            const int h = col - 16; const float xx = v + p.dt_bias[h];
                            const float sp = xx > 20.f ? xx : log1pf(__expf(xx));
                            gg[t * 8 + h] = -__expf(p.a_log[h]) * sp;
                        }
                    }
            }
        } else if (C0 < 4224) {
            half_t* dst; int ld, cb;
            if (C0 < 3712) { dst = gqkv; ld = 1536; cb = C0 - 2176; } else { dst = gz; ld = 512; cb = C0 - 3712; }
#pragma unroll
            for (int m = 0; m < 4; ++m) {
                const int t = R0 + m * 16 + fr;
#pragma unroll
                for (int n = 0; n < 4; ++n) store_h4(dst + (long)t * ld + cb + n * 16 + 4 * fq, acc[m][n][0], acc[m][n][1], acc[m][n][2], acc[m][n][3]);
            }
        } else if (C0 < 6272) {
            const int cb = C0 - 4224;
#pragma unroll
            for (int m = 0; m < 4; ++m) {
                const int t = R0 + m * 16 + fr;
#pragma unroll
                for (int n = 0; n < 4; ++n) store_h4(gates + (long)t * 2048 + cb + n * 16 + 4 * fq, sigmoidf_(acc[m][n][0]), sigmoidf_(acc[m][n][1]), sigmoidf_(acc[m][n][2]), sigmoidf_(acc[m][n][3]));
            }
        }
    }
}

__device__ __forceinline__ u32 fkey(float x) { const u32 b = __float_as_uint(x); return (b & 0x80000000u) ? ~b : (b | 0x80000000u); }
template <int CTRL> __device__ __forceinline__ u32 dpp_add(u32 v) { return v + (u32)__builtin_amdgcn_update_dpp(0, (int)v, CTRL, 0xf, 0xf, false); }
__device__ __forceinline__ u32 row16_sum(u32 v) {
    v = dpp_add<0xB1>(v);
    v = dpp_add<0x4E>(v);
    v = dpp_add<0x141>(v);
    v = dpp_add<0x140>(v);
    return v;
}

__device__ __forceinline__ void dsa_select_unit(const Params& p, char* lds, int b, int q8) {
    const int tid = threadIdx.x, wid = tid >> 6, lane = tid & 63, fr = lane & 15, fq = lane >> 4;
    const half_t* qi = (const half_t*)(p.ws + OFF_RB + 50331648ull); const half_t* ki = (const half_t*)(p.ws + OFF_RB + 67108864ull);
    const float* wi = (const float*)(p.ws + OFF_RB + 69206016ull);
    u16* mask = (u16*)(p.ws + OFF_MASK);
    const long tb = (long)b * SEQ; const int t0 = q8 * 8;
    const int dt = (t0 + 7) >> 4;
    const int nkt = dt + 1, per = (nkt + 7) >> 3;
    const int ktb = wid * per;
    int ntw = nkt - ktb; ntw = ntw < 0 ? 0 : (ntw > per ? per : ntw);
    const float NEG_INF = -__builtin_inff();
    float sc[32][2];
#pragma unroll
    for (int i = 0; i < 32; ++i) { sc[i][0] = NEG_INF; sc[i][1] = NEG_INF; }
    h8 aq[4][2]; float w[4][4];
#pragma unroll
    for (int hp = 0; hp < 4; ++hp) {
#pragma unroll
        for (int ks = 0; ks < 2; ++ks) aq[hp][ks] = *(const h8*)(qi + (tb + t0 + (fr >> 1)) * 512 + (hp * 2 + (fr & 1)) * 64 + ks * 32 + fq * 8);
#pragma unroll
        for (int j = 0; j < 4; ++j) w[hp][j] = wi[(tb + t0 + 2 * fq + (j >> 1)) * 8 + hp * 2 + (j & 1)] * 0.04419417382415922f;
    }
    const half_t* kp = ki + (tb + (long)ktb * 16 + fr) * 64 + fq * 8;
    h8 cb0, cb1, nb0, nb1;
    if (ntw > 0) { cb0 = *(const h8*)(kp); cb1 = *(const h8*)(kp + 32); }
    if (ntw > 1) { nb0 = *(const h8*)(kp + 1024); nb1 = *(const h8*)(kp + 1024 + 32); }
#pragma unroll
    for (int i = 0; i < 32; ++i) {
        if (i < ntw) {
            h8 fb0, fb1;
            if (i + 2 < ntw) { fb0 = *(const h8*)(kp + (i + 2) * 1024); fb1 = *(const h8*)(kp + (i + 2) * 1024 + 32); }
            float s0 = 0.f, s1 = 0.f;
#pragma unroll
            for (int hp = 0; hp < 4; ++hp) {
                f4 a = {0.f, 0.f, 0.f, 0.f};
                a = mfma16(aq[hp][0], cb0, a); a = mfma16(aq[hp][1], cb1, a);
                s0 += w[hp][0] * fmaxf(a[0], 0.f) + w[hp][1] * fmaxf(a[1], 0.f);
                s1 += w[hp][2] * fmaxf(a[2], 0.f) + w[hp][3] * fmaxf(a[3], 0.f);
            }
            if (ktb + i == dt) { const int key = dt * 16 + fr; if (key > t0 + 2 * fq) s0 = NEG_INF; if (key > t0 + 2 * fq + 1) s1 = NEG_INF; }
            sc[i][0] = __uint_as_float(fkey(s0)); sc[i][1] = __uint_as_float(fkey(s1));
            cb0 = nb0; cb1 = nb1; nb0 = fb0; nb1 = fb1;
        } else { sc[i][0] = __uint_as_float(fkey(NEG_INF)); sc[i][1] = sc[i][0]; }
    }
#define KK(i, j) __float_as_uint(sc[i][j])
    u32 K[2]; bool done[2];
#pragma unroll
    for (int j = 0; j < 2; ++j) { K[j] = 0u; done[j] = (t0 + 2 * fq + j + 1) <= 256; }
    u32* part = (u32*)lds;
    if (t0 + 8 > 256) {
        for (int bit = 31; bit >= 0; --bit) {
            const u32 cand0 = K[0] | (1u << bit), cand1 = K[1] | (1u << bit);
            u32 c0 = 0u, c1 = 0u;
#pragma unroll
            for (int i = 0; i < 32; ++i) { c0 += (KK(i, 0) >= cand0) ? 1u : 0u; c1 += (KK(i, 1) >= cand1) ? 1u : 0u; }
            const u32 cc = row16_sum(c0 | (c1 << 16));
            u32* pp = part + (bit & 1) * 32;
            if (fr == 0) pp[wid * 4 + fq] = cc;
            __syncthreads();
            u32 tt = 0u;
#pragma unroll
            for (int w8 = 0; w8 < 8; ++w8) tt += pp[w8 * 4 + fq];
            const u32 tot0 = tt & 0xffffu, tot1 = tt >> 16;
            if (!done[0] && tot0 >= 256u) { K[0] = cand0; if (tot0 == 256u) done[0] = true; }
            if (!done[1] && tot1 >= 256u) { K[1] = cand1; if (tot1 == 256u) done[1] = true; }
            if (__all(done[0] && done[1])) break;
        }
    }
#pragma unroll
    for (int j = 0; j < 2; ++j) K[j] = K[j] < 0x00800000u ? 0x00800000u : K[j];
#pragma unroll
    for (int i = 0; i < 32; ++i) {
        if (i < ntw) {
#pragma unroll
            for (int j = 0; j < 2; ++j) {
                const unsigned long long bm = __ballot(KK(i, j) >= K[j]);
                if (fr == 0) mask[(tb + t0 + 2 * fq + j) * 256 + ktb + i] = (u16)((bm >> (16 * fq)) & 0xffffull);
            }
        }
    }
#undef KK
    {
        const int tend = ((t0 + 8 + 127) >> 7) * 8;
        if (tid < 64) { const int row = tid >> 3, tile = nkt + (tid & 7); if (tile < tend) mask[(tb + t0 + row) * 256 + tile] = (u16)0; }
    }
    __syncthreads();
}

#define G1_GRP_BYTES (3 * 64 * 65 * 4 + 64 * 64 * 4 + 3 * 64 * 4)
__device__ __forceinline__ void gdn_prep_unit(const Params& p, char* lds, int b, int ch, int hp) {
    const int tid = threadIdx.x, grp = tid >> 8, gt = tid & 255, h = hp * 2 + grp;
    float* qs = (float*)(lds + grp * G1_GRP_BYTES);
    float* ks = qs + 64 * 65; float* vs = ks + 64 * 65; float* Ls = vs + 64 * 65;
    float* gcs = Ls + 64 * 64; float* bts = gcs + 64; float* egs = bts + 64;
    const half_t* gqkv = (const half_t*)(p.ws + OFF_GQKV);
    const float* beta = (const float*)(p.ws + OFF_BETA); const float* gg = (const float*)(p.ws + OFF_G);
    const long tb = (long)b * SEQ; const int s0 = ch * 64;
    const long ui = ((long)(b * 8 + h) * 64 + ch) * 4096;
    half_t* UT = (half_t*)(p.ws + OFF_RA) + ui; half_t* Wm = (half_t*)(p.ws + OFF_RA + 16777216ull) + ui;
    half_t* QG = (half_t*)(p.ws + OFF_RB) + ui; half_t* AQ = (half_t*)(p.ws + OFF_RB + 16777216ull) + ui; half_t* KDT = (half_t*)(p.ws + OFF_RB + 33554432ull) + ui;
    float* GL = (float*)(p.ws + OFF_GL);
    __syncthreads();
    {
        const int tok = gt >> 2, cgp = gt & 3;
#pragma unroll
        for (int part = 0; part < 3; ++part) {
            float* dstb = part == 0 ? qs : (part == 1 ? ks : vs);
#pragma unroll
            for (int c8 = 0; c8 < 2; ++c8) {
                const int c = cgp * 16 + c8 * 8, gc_ = part * 512 + h * 64 + c;
                float y[8] = {0.f, 0.f, 0.f, 0.f, 0.f, 0.f, 0.f, 0.f};
#pragma unroll
                for (int d = 0; d < 4; ++d) {
                    const int s = s0 + tok + d - 3;
                    if (s >= 0) {
                        const h8 xv = *(const h8*)(gqkv + (tb + s) * 1536 + gc_);
                        const f4 w0 = *(const f4*)(p.conv_w + d * 1536 + gc_), w1 = *(const f4*)(p.conv_w + d * 1536 + gc_ + 4);
#pragma unroll
                        for (int e = 0; e < 4; ++e) { y[e] += (float)xv[e] * w0[e]; y[4 + e] += (float)xv[4 + e] * w1[e]; }
                    }
                }
#pragma unroll
                for (int e = 0; e < 8; ++e) dstb[tok * 65 + c + e] = siluf_(y[e]);
            }
        }
    }
    __syncthreads();
    {
        const int tok = gt >> 2, cgp = gt & 3;
        float sq = 0.f, sk = 0.f;
#pragma unroll
        for (int e = 0; e < 16; ++e) { const float a = qs[tok * 65 + cgp * 16 + e], c2 = ks[tok * 65 + cgp * 16 + e]; sq += a * a; sk += c2 * c2; }
        sq += __shfl_xor(sq, 1); sq += __shfl_xor(sq, 2); sk += __shfl_xor(sk, 1); sk += __shfl_xor(sk, 2);
        const float rq = rsqrtf(sq + 1e-6f) * 0.125f, rk = rsqrtf(sk + 1e-6f);
#pragma unroll
        for (int e = 0; e < 16; ++e) { qs[tok * 65 + cgp * 16 + e] *= rq; ks[tok * 65 + cgp * 16 + e] *= rk; }
        if (gt < 64) {
            float g = gg[(tb + s0 + gt) * 8 + h];
#pragma unroll
            for (int o = 1; o < 64; o <<= 1) { const float n = __shfl_up(g, o); if (gt >= o) g += n; }
            gcs[gt] = g; bts[gt] = beta[(tb + s0 + gt) * 8 + h]; egs[gt] = __expf(g);
        }
    }
    __syncthreads();
    {
        const float gl = gcs[63];
        if (gt == 0) GL[(b * 8 + h) * 64 + ch] = __expf(gl);
        {
            const int tok = gt >> 2, c0 = (gt & 3) * 16; const float eg = egs[tok];
#pragma unroll
            for (int e8 = 0; e8 < 2; ++e8) { h8 o;
_Pragma("unroll") for (int e = 0; e < 8; ++e) o[e] = (half_t)(qs[tok * 65 + c0 + e8 * 8 + e] * eg); *(h8*)(QG + tok * 64 + c0 + e8 * 8) = o; }
            const int dk = gt >> 2, t0_ = (gt & 3) * 16;
#pragma unroll
            for (int e8 = 0; e8 < 2; ++e8) { h8 o;
_Pragma("unroll") for (int e = 0; e < 8; ++e) { const int tk = t0_ + e8 * 8 + e; o[e] = (half_t)(ks[tk * 65 + dk] * __expf(gl - gcs[tk])); } *(h8*)(KDT + dk * 64 + t0_ + e8 * 8) = o; }
        }
        const int i = gt >> 2, j0 = (gt & 3) * 16;
        float aq[16], lk[16];
#pragma unroll
        for (int jj = 0; jj < 16; ++jj) { aq[jj] = 0.f; lk[jj] = 0.f; }
        for (int d = 0; d < 64; ++d) {
            const float qv = qs[i * 65 + d], kv = ks[i * 65 + d];
#pragma unroll
            for (int jj = 0; jj < 16; ++jj) { const float kj = ks[(j0 + jj) * 65 + d]; aq[jj] += qv * kj; lk[jj] += kv * kj; }
        }
        const float gi = gcs[i], bi = bts[i];
        h8 o0, o1;
#pragma unroll
        for (int jj = 0; jj < 16; ++jj) {
            const int j = j0 + jj; const float dec = (j <= i) ? __expf(gi - gcs[j]) : 0.f;
            const float av = aq[jj] * dec;
            if (jj < 8) o0[jj] = (half_t)av; else o1[jj - 8] = (half_t)av;
            Ls[i * 64 + j] = (j < i) ? bi * lk[jj] * dec : 0.f;
        }
        *(h8*)(AQ + i * 64 + j0) = o0; *(h8*)(AQ + i * 64 + j0 + 8) = o1;
    }
    __syncthreads();
    {
        const int tok = gt >> 2, c0 = (gt & 3) * 16; const float bt = bts[tok], be = bt * egs[tok];
#pragma unroll
        for (int e = 0; e < 16; ++e) { vs[tok * 65 + c0 + e] *= bt; ks[tok * 65 + c0 + e] *= be; }
    }
    __syncthreads();
    if (gt < 128) {
        const int c = gt;
        const float* rb = (c < 64 ? vs : ks) + (c & 63);
        float xr[64];
#pragma unroll
        for (int i = 0; i < 64; ++i) {
            float a = rb[i * 65];
#pragma unroll
            for (int j4 = 0; j4 < (i + 3) / 4; ++j4) {
                const f4 l = *(const f4*)(Ls + i * 64 + j4 * 4);
#pragma unroll
                for (int e = 0; e < 4; ++e) if (j4 * 4 + e < i) a -= l[e] * xr[j4 * 4 + e];
            }
            xr[i] = a;
            asm volatile("" ::: "memory");
        }
        if (c < 64) {
#pragma unroll
            for (int e8 = 0; e8 < 8; ++e8) { h8 o;
_Pragma("unroll") for (int e = 0; e < 8; ++e) o[e] = (half_t)xr[e8 * 8 + e]; *(h8*)(UT + c * 64 + e8 * 8) = o; }
        } else {
#pragma unroll
            for (int i = 0; i < 64; ++i) Wm[i * 64 + (c - 64)] = (half_t)xr[i];
        }
    }
    __syncthreads();
}

#define P3_SEL_UNITS 2048
#define P3_GDN_UNITS 1024
__device__ __forceinline__ void phase3(const Params& p, char* lds, int bid, int nb) {
#pragma unroll 1
    for (int u = bid; u < P3_SEL_UNITS; u += nb) dsa_select_unit(p, lds, u & 3, 511 - (u >> 2));
#pragma unroll 1
    for (int v = bid; v < P3_GDN_UNITS; v += nb) gdn_prep_unit(p, lds, v >> 8, (v >> 2) & 63, v & 3);
}

__device__ __forceinline__ void gdn_scan_unit(const Params& p, char* lds, int b, int h) {
    const int tid = threadIdx.x, wid = tid >> 6, lane = tid & 63, fr = lane & 15, fq = lane >> 4;
    const int mi = wid >> 1, nj0 = (wid & 1) * 2;
    char* S16 = lds; char* VN16 = lds + 8192; float* Ob = (float*)(lds + 16384);
    const long ub = (long)(b * 8 + h) * 64 * 4096;
    const half_t* UT = (const half_t*)(p.ws + OFF_RA) + ub; const half_t* Wm = (const half_t*)(p.ws + OFF_RA + 16777216ull) + ub;
    const half_t* QG = (const half_t*)(p.ws + OFF_RB) + ub; const half_t* AQ = (const half_t*)(p.ws + OFF_RB + 16777216ull) + ub; const half_t* KDT = (const half_t*)(p.ws + OFF_RB + 33554432ull) + ub;
    const float* GL = (const float*)(p.ws + OFF_GL) + (b * 8 + h) * 64;
    const half_t* gz = (const half_t*)(p.ws + OFF_GZ);
    half_t* og = (half_t*)(p.ws + OFF_GQKV + 16777216ull);
    const long tb = (long)b * SEQ;
    f4 S[2] = {{0.f, 0.f, 0.f, 0.f}, {0.f, 0.f, 0.f, 0.f}};
    __syncthreads();
#pragma unroll
    for (int n = 0; n < 2; ++n) { h4 z = {(half_t)0.f, (half_t)0.f, (half_t)0.f, (half_t)0.f}; *(h4*)(S16 + swz((nj0 + n) * 16 + fr, mi * 2 + (fq >> 1)) + (fq & 1) * 8) = z; }
    __syncthreads();
    const int arow = (mi * 16 + fr) * 64 + fq * 8;
    for (int c = 0; c < 64; ++c) {
        const half_t* cW = Wm + c * 4096; const half_t* cQ = QG + c * 4096; const half_t* cA = AQ + c * 4096; const half_t* cK = KDT + c * 4096; const half_t* cU = UT + c * 4096;
        h8 fw[2], fqg[2], fa[2], fk[2]; h4 fu[2];
#pragma unroll
        for (int ks = 0; ks < 2; ++ks) { fw[ks] = *(const h8*)(cW + arow + ks * 32); fqg[ks] = *(const h8*)(cQ + arow + ks * 32); fa[ks] = *(const h8*)(cA + arow + ks * 32); fk[ks] = *(const h8*)(cK + arow + ks * 32); }
#pragma unroll
        for (int n = 0; n < 2; ++n) fu[n] = *(const h4*)(cU + ((nj0 + n) * 16 + fr) * 64 + mi * 16 + 4 * fq);
        const float gl = GL[c];
        f4 t1[2], o[2];
#pragma unroll
        for (int n = 0; n < 2; ++n) {
            t1[n] = (f4){0.f, 0.f, 0.f, 0.f}; o[n] = (f4){0.f, 0.f, 0.f, 0.f};
#pragma unroll
            for (int ks = 0; ks < 2; ++ks) {
                const h8 bs = *(const h8*)(S16 + swz((nj0 + n) * 16 + fr, ks * 4 + fq));
                t1[n] = mfma16(fw[ks], bs, t1[n]); o[n] = mfma16(fqg[ks], bs, o[n]);
            }
            h4 vn;
#pragma unroll
            for (int j = 0; j < 4; ++j) vn[j] = (half_t)((float)fu[n][j] - t1[n][j]);
            *(h4*)(VN16 + swz((nj0 + n) * 16 + fr, mi * 2 + (fq >> 1)) + (fq & 1) * 8) = vn;
        }
        __syncthreads();
#pragma unroll
        for (int n = 0; n < 2; ++n) {
            S[n] = S[n] * gl;
#pragma unroll
            for (int ks = 0; ks < 2; ++ks) {
                const h8 bv = *(const h8*)(VN16 + swz((nj0 + n) * 16 + fr, ks * 4 + fq));
                o[n] = mfma16(fa[ks], bv, o[n]); S[n] = mfma16(fk[ks], bv, S[n]);
            }
            h4 sn;
#pragma unroll
            for (int j = 0; j < 4; ++j) { sn[j] = (half_t)S[n][j]; Ob[(mi * 16 + 4 * fq + j) * 65 + (nj0 + n) * 16 + fr] = o[n][j]; }
            *(h4*)(S16 + swz((nj0 + n) * 16 + fr, mi * 2 + (fq >> 1)) + (fq & 1) * 8) = sn;
        }
        __syncthreads();
        {
            const int tok = tid >> 3, d0 = (tid & 7) * 8;
            float v[8], ss = 0.f;
#pragma unroll
            for (int e = 0; e < 8; ++e) { v[e] = Ob[tok * 65 + d0 + e]; ss += v[e] * v[e]; }
            ss += __shfl_xor(ss, 1); ss += __shfl_xor(ss, 2); ss += __shfl_xor(ss, 4);
            const float rstd = rsqrtf(ss * (1.0f / 64.0f) + 1e-6f);
            const long t = tb + c * 64 + tok;
            const h8 z = *(const h8*)(gz + t * 512 + h * 64 + d0);
            h8 ov;
#pragma unroll
            for (int e = 0; e < 8; ++e) ov[e] = (half_t)(v[e] * rstd * p.gdn_norm[d0 + e] * siluf_((float)z[e]));
            *(h8*)(og + t * 512 + h * 64 + d0) = ov;
        }
    }
    __syncthreads();
}

#define VT_STRIDE 136
__device__ __forceinline__ void attn_unit(const Params& p, char* lds, int b, int h, int qt) {
    const int tid = threadIdx.x, wid = tid >> 6, lane = tid & 63, fr = lane & 15, fq = lane >> 4;
    const half_t* qb = (const half_t*)(p.ws + OFF_QKV); const half_t* kb = qb + (long)T_TOK * 512; const half_t* vT = kb + (long)T_TOK * 512;
    const u16* mask = (const u16*)(p.ws + OFF_MASK);
    half_t* ya = (half_t*)(p.ws + OFF_GQKV);
    const long tb = (long)b * SEQ; const int q0 = qt * 128, qw = q0 + wid * 16;
    const int nkt = 2 * qt + 2;
    const long tq = tb + qw + fr;
    h8 bq[2];
#pragma unroll
    for (int ks = 0; ks < 2; ++ks) bq[ks] = *(const h8*)(qb + tq * 512 + h * 64 + ks * 32 + fq * 8);
    const half_t* kbase = kb + tb * 512 + h * 64; const half_t* vbase = vT + (long)(b * 8 + h) * 64 * SEQ;
    const int lrow = tid >> 3, lch = tid & 7;
    char* Kt[2] = {lds, lds + 8192}; char* Vt[2] = {lds + 16384, lds + 16384 + 64 * VT_STRIDE};
    float m_run = -1e30f, l_run = 0.f;
    f4 oacc[4];
#pragma unroll
    for (int m = 0; m < 4; ++m) oacc[m] = (f4){0.f, 0.f, 0.f, 0.f};
    __syncthreads();
    uint4 rk = *(const uint4*)(kbase + (long)lrow * 512 + lch * 8);
    uint4 rv = *(const uint4*)(vbase + (long)lrow * SEQ + lch * 8);
    *(uint4*)(Kt[0] + swz(lrow, lch)) = rk;
    *(uint2*)(Vt[0] + lrow * VT_STRIDE + lch * 16) = make_uint2(rv.x, rv.y); *(uint2*)(Vt[0] + lrow * VT_STRIDE + lch * 16 + 8) = make_uint2(rv.z, rv.w);
    __syncthreads();
    for (int kt = 0; kt < nkt; ++kt) {
        const bool more = kt + 1 < nkt;
        if (more) {
            rk = *(const uint4*)(kbase + (long)((kt + 1) * 64 + lrow) * 512 + lch * 8);
            rv = *(const uint4*)(vbase + (long)lrow * SEQ + (kt + 1) * 64 + lch * 8);
        }
        const char* K_ = Kt[kt & 1]; const char* V_ = Vt[kt & 1];
        const uint2 mw = *(const uint2*)(mask + tq * 256 + kt * 4);
        f4 st[4];
#pragma unroll
        for (int m = 0; m < 4; ++m) {
            st[m] = (f4){0.f, 0.f, 0.f, 0.f};
#pragma unroll
            for (int ks = 0; ks < 2; ++ks) st[m] = mfma16(*(const h8*)(K_ + swz(m * 16 + fr, ks * 4 + fq)), bq[ks], st[m]);
        }
        const u32 wbits[4] = {mw.x & 0xffffu, mw.x >> 16, mw.y & 0xffffu, mw.y >> 16};
        float mx = -1e30f;
#pragma unroll
        for (int m = 0; m < 4; ++m)
#pragma unroll
            for (int j = 0; j < 4; ++j) {
                const bool valid = (wbits[m] >> (4 * fq + j)) & 1u;
                st[m][j] = valid ? st[m][j] * 0.125f : -1e30f;
                mx = fmaxf(mx, st[m][j]);
            }
        mx = fmaxf(mx, __shfl_xor(mx, 16)); mx = fmaxf(mx, __shfl_xor(mx, 32));
        const float m_new = fmaxf(m_run, mx);
        const float alpha = __expf(m_run - m_new);
        m_run = m_new;
        float ps = 0.f;
#pragma unroll
        for (int m = 0; m < 4; ++m)
#pragma unroll
            for (int j = 0; j < 4; ++j) { const float pv = (st[m][j] > -1e29f) ? __expf(st[m][j] - m_new) : 0.f; st[m][j] = pv; ps += pv; }
        l_run = l_run * alpha + ps;
#pragma unroll
        for (int m = 0; m < 4; ++m) oacc[m] = oacc[m] * alpha;
#pragma unroll
        for (int ks = 0; ks < 2; ++ks) {
            h8 bp;
#pragma unroll
            for (int j = 0; j < 4; ++j) { bp[j] = (half_t)st[2 * ks][j]; bp[4 + j] = (half_t)st[2 * ks + 1][j]; }
#pragma unroll
            for (int m = 0; m < 4; ++m) {
                const h4 lo = *(const h4*)(V_ + (m * 16 + fr) * VT_STRIDE + (ks * 32 + 4 * fq) * 2);
                const h4 hi = *(const h4*)(V_ + (m * 16 + fr) * VT_STRIDE + (ks * 32 + 16 + 4 * fq) * 2);
                h8 av;
#pragma unroll
                for (int j = 0; j < 4; ++j) { av[j] = lo[j]; av[4 + j] = hi[j]; }
                oacc[m] = mfma16(av, bp, oacc[m]);
            }
        }
        if (more) {
            *(uint4*)(Kt[(kt + 1) & 1] + swz(lrow, lch)) = rk;
            char* vd = Vt[(kt + 1) & 1] + lrow * VT_STRIDE + lch * 16;
            *(uint2*)vd = make_uint2(rv.x, rv.y); *(uint2*)(vd + 8) = make_uint2(rv.z, rv.w);
        }
        __syncthreads();
    }
    l_run += __shfl_xor(l_run, 16); l_run += __shfl_xor(l_run, 32);
    const float inv = 1.0f / l_run;
#pragma unroll
    for (int m = 0; m < 4; ++m) store_h4(ya + tq * 512 + h * 64 + m * 16 + 4 * fq, oacc[m][0] * inv, oacc[m][1] * inv, oacc[m][2] * inv, oacc[m][3] * inv);
}

#define P4_ATTN_UNITS 1024
__device__ __forceinline__ void phase4(const Params& p, char* lds, int bid, int nb) {
    if (bid < 32) gdn_scan_unit(p, lds, bid >> 3, bid & 7);
    u32* ctr = (u32*)(p.ws + OFF_CTRL);
    __shared__ u32 s_unit;
    for (;;) {
        __syncthreads();
        if (threadIdx.x == 0) s_unit = atomicAdd(ctr, 1u);
        __syncthreads();
        const u32 u = s_unit;
        if (u >= P4_ATTN_UNITS) break;
        attn_unit(p, lds, u & 3, (u >> 2) & 7, 31 - (u >> 5));
    }
}

__device__ __forceinline__ void phase5a(const Params& p, char* lds, int bid, int nb) {
    const int tid = threadIdx.x, wid = tid >> 6, lane = tid & 63, wm = wid >> 1, wn = wid & 1, fr = lane & 15, fq = lane >> 4;
    const half_t* ya = (const half_t*)(p.ws + OFF_GQKV); const half_t* og = ya + (long)T_TOK * 512;
    const half_t* wbd = (const half_t*)(p.ws + OFF_WBD); const half_t* wbg = (const half_t*)(p.ws + OFF_WBG);
    const half_t* gates = (const half_t*)p.out;
    half_t* merged = (half_t*)(p.ws + OFF_RA);
    for (int u = bid; u < 64 * 8; u += nb) {
        const int mt = u >> 3, nt = u & 7;
        f4 aa[4][4], ab[4][4]; zero_acc(aa); zero_acc(ab);
        gemm_accum<4, 2>(lds, 512, RowLoad{ya + (long)mt * 256 * 512, 512}, RowLoad{wbd + (long)nt * 128 * 512, 512}, aa);
        gemm_accum<4, 2>(lds, 512, RowLoad{og + (long)mt * 256 * 512, 512}, RowLoad{wbg + (long)nt * 128 * 512, 512}, ab);
#pragma unroll
        for (int m = 0; m < 4; ++m) {
            const long t = mt * 256 + wm * 64 + m * 16 + fr;
#pragma unroll
            for (int n = 0; n < 4; ++n) {
                const int col = nt * 128 + wn * 64 + n * 16 + 4 * fq;
                const h4 sa = *(const h4*)(gates + t * 2048 + col), sb = *(const h4*)(gates + t * 2048 + 1024 + col);
                store_h4(merged + t * 1024 + col, (float)sa[0] * aa[m][n][0] + (float)sb[0] * ab[m][n][0], (float)sa[1] * aa[m][n][1] + (float)sb[1] * ab[m][n][1],
                         (float)sa[2] * aa[m][n][2] + (float)sb[2] * ab[m][n][2], (float)sa[3] * aa[m][n][3] + (float)sb[3] * ab[m][n][3]);
            }
        }
    }
}

__device__ __forceinline__ void phase5b(const Params& p, char* lds, int bid, int nb) {
    const int tid = threadIdx.x, wid = tid >> 6, lane = tid & 63, wm = wid >> 1, wn = wid & 1, fr = lane & 15, fq = lane >> 4;
    const half_t* merged = (const half_t*)(p.ws + OFF_RA); const half_t* wo = (const half_t*)(p.ws + OFF_WO);
    float* ybuf = (float*)(p.ws + OFF_RB);
    for (int u = bid; u < 64 * 8; u += nb) {
        const int mt = u >> 3, nt = u & 7;
        f4 acc[4][4]; zero_acc(acc);
        gemm_accum<4, 2>(lds, 1024, RowLoad{merged + (long)mt * 256 * 1024, 1024}, RowLoad{wo + (long)nt * 128 * 1024, 1024}, acc);
#pragma unroll
        for (int m = 0; m < 4; ++m) {
            const long t = mt * 256 + wm * 64 + m * 16 + fr;
#pragma unroll
            for (int n = 0; n < 4; ++n) *(f4*)(ybuf + t * 1024 + nt * 128 + wn * 64 + n * 16 + 4 * fq) = acc[m][n];
        }
    }
}

__device__ __forceinline__ void token_mid(const Params& p, int t) {
    const int lane = threadIdx.x & 63, b = t >> 12;
    const float* mod = (const float*)(p.ws + OFF_MOD) + b * 6144;
    const float* ybuf = (const float*)(p.ws + OFF_RB);
    half_t* h2b = (half_t*)(p.ws + OFF_RA);
    f4 y[4], x1[4]; float ss = 0.f;
#pragma unroll
    for (int i = 0; i < 4; ++i) { y[i] = *(const f4*)(ybuf + (long)t * 1024 + i * 256 + lane * 4); ss += y[i][0] * y[i][0] + y[i][1] * y[i][1] + y[i][2] * y[i][2] + y[i][3] * y[i][3]; }
    ss = wave_sum(ss);
    const float r1 = rsqrtf(ss * (1.0f / DM) + 1e-6f);
    float ss2 = 0.f;
#pragma unroll
    for (int i = 0; i < 4; ++i) {
        const int c = i * 256 + lane * 4;
        const f4 xv = *(const f4*)(p.x + (long)t * 1024 + c), w = *(const f4*)(p.norm_post1 + c), g1 = *(const f4*)(mod + 2048 + c);
#pragma unroll
        for (int j = 0; j < 4; ++j) { x1[i][j] = xv[j] + g1[j] * (y[i][j] * r1 * w[j]); ss2 += x1[i][j] * x1[i][j]; }
        *(f4*)(p.out + (long)t * 1024 + c) = x1[i];
    }
    ss2 = wave_sum(ss2);
    const float r2 = rsqrtf(ss2 * (1.0f / DM) + 1e-6f);
    float lg[4] = {0.f, 0.f, 0.f, 0.f}, le[16];
#pragma unroll
    for (int e = 0; e < 16; ++e) le[e] = 0.f;
#pragma unroll
    for (int i = 0; i < 4; ++i) {
        const int c = i * 256 + lane * 4;
        const f4 w = *(const f4*)(p.norm_pre2 + c), sh = *(const f4*)(mod + 3072 + c), sc = *(const f4*)(mod + 4096 + c);
        float hv[4];
#pragma unroll
        for (int j = 0; j < 4; ++j) hv[j] = x1[i][j] * r2 * w[j] * (1.0f + sc[j]) + sh[j];
        store_h4(h2b + (long)t * 1024 + c, hv[0], hv[1], hv[2], hv[3]);
#pragma unroll
        for (int j = 0; j < 4; ++j) {
            const f4 wg = *(const f4*)(p.w_rg + (c + j) * 4);
#pragma unroll
            for (int g = 0; g < 4; ++g) lg[g] += hv[j] * wg[g];
#pragma unroll
            for (int e4 = 0; e4 < 4; ++e4) {
                const f4 we = *(const f4*)(p.w_re + (c + j) * 16 + e4 * 4);
#pragma unroll
                for (int e = 0; e < 4; ++e) le[e4 * 4 + e] += hv[j] * we[e];
            }
        }
    }
#pragma unroll
    for (int g = 0; g < 4; ++g) lg[g] = wave_sum(lg[g]) + p.b_rg[g];
#pragma unroll
    for (int e = 0; e < 16; ++e) le[e] = wave_sum(le[e]) + p.b_re[e];
    int gid = 0; float gmax = lg[0];
#pragma unroll
    for (int g = 1; g < 4; ++g) if (lg[g] > gmax) { gmax = lg[g]; gid = g; }
    float gsum = 0.f;
#pragma unroll
    for (int g = 0; g < 4; ++g) gsum += __expf(lg[g] - gmax);
    const float g_w = 1.0f / gsum;
    float li[4];
#pragma unroll
    for (int e = 0; e < 4; ++e) li[e] = gid == 0 ? le[e] : (gid == 1 ? le[4 + e] : (gid == 2 ? le[8 + e] : le[12 + e]));
    int e1 = 0; float m1 = li[0];
#pragma unroll
    for (int e = 1; e < 4; ++e) if (li[e] > m1) { m1 = li[e]; e1 = e; }
    int e2 = -1; float m2 = -3.0e38f;
#pragma unroll
    for (int e = 0; e < 4; ++e) if (e != e1 && li[e] > m2) { m2 = li[e]; e2 = e; }
    const float p2 = __expf(m2 - m1);
    const float w1 = g_w / (1.0f + p2), w2 = g_w * p2 / (1.0f + p2);
    const int lo = e1 < e2 ? e1 : e2, hi = e1 < e2 ? e2 : e1;
    const float wlo = e1 < e2 ? w1 : w2, whi = e1 < e2 ? w2 : w1;
    const int cls = gid * 6 + (lo * (7 - lo)) / 2 + (hi - lo - 1);
    if (lane == 0) {
        u32* cnt = (u32*)(p.ws + OFF_CTRL) + 16;
        const u32 pos = atomicAdd(cnt + cls, 1u);
        ((int*)(p.ws + OFF_LIST))[cls * T_TOK + pos] = t;
        float* tk = (float*)(p.ws + OFF_TOK) + (long)t * 2;
        tk[0] = wlo; tk[1] = whi;
    }
}

#define P5C_TOK_UNITS 2048
#define P5C_EXP_UNITS 3072
__device__ __forceinline__ void phase5c(const Params& p, char* lds, int bid, int nb) {
    for (int u = bid; u < P5C_TOK_UNITS + P5C_EXP_UNITS; u += nb) {
        if (u < P5C_TOK_UNITS) token_mid(p, u * 8 + (threadIdx.x >> 6));
        else expert_convert_unit(p, lds, u - P5C_TOK_UNITS);
    }
}

struct MoeMap { int cnt[24]; int moff[25]; };
__device__ __forceinline__ void moe_map_build(const Params& p, MoeMap* mm) {
    __syncthreads();
    if (threadIdx.x == 0) {
        const u32* cnt = (const u32*)(p.ws + OFF_CTRL) + 16; int o = 0;
        for (int c = 0; c < 24; ++c) { const int n = (int)cnt[c]; mm->cnt[c] = n; mm->moff[c] = o; o += (n + 127) >> 7; }
        mm->moff[24] = o;
    }
    __syncthreads();
}
__device__ __forceinline__ void cls_experts(int c, int& elo, int& ehi) {
    const int g = c / 6, pi = c % 6;
    const int lo = pi < 3 ? 0 : (pi < 5 ? 1 : 2), hi = pi < 3 ? pi + 1 : (pi < 5 ? pi - 1 : 3);
    elo = g * 4 + lo; ehi = g * 4 + hi;
}
struct TokRowLoad {
    const half_t* h2; const int* list; int base, cnt;
    __device__ __forceinline__ const half_t* operator()(int r) const { const int pp = base + r; return h2 + (long)list[pp < cnt ? pp : 0] * 1024; }
};

__device__ __forceinline__ void phase6a(const Params& p, char* lds, int bid, int nb) {
    __shared__ MoeMap mm;
    moe_map_build(p, &mm);
    const int tid = threadIdx.x, wid = tid >> 6, lane = tid & 63, wm = wid >> 2, wn = wid & 3, fr = lane & 15, fq = lane >> 4;
    const half_t* h2b = (const half_t*)(p.ws + OFF_RA);
    const half_t* weg = (const half_t*)(p.ws + OFF_GQKV);
    const int* list = (const int*)(p.ws + OFF_LIST);
    const float* tokw = (const float*)(p.ws + OFF_TOK);
    half_t* act = (half_t*)(p.ws + OFF_QKV);
    const int total = mm.moff[24] * 4;
    for (int u = bid; u < total; u += nb) {
        const int mtg = u >> 2, nt = u & 3;
        int c = 0;
#pragma unroll 1
        for (int cc = 1; cc < 24; ++cc) if (mm.moff[cc] <= mtg) c = cc;
        const int i = mtg - mm.moff[c], cnt = mm.cnt[c];
        int elo, ehi; cls_experts(c, elo, ehi);
        const int es = nt >> 1;
        const int e = es ? ehi : elo;
        f4 acc[4][4]; zero_acc(acc);
        gemm_accum<2, 4>(lds, 1024, TokRowLoad{h2b, list + c * T_TOK, i * 128, cnt}, RowLoad{weg + ((long)e * 512 + (nt & 1) * 256) * 1024, 1024}, acc);
        const int fb = ((nt & 1) * 256 + wn * 64) >> 6;
#pragma unroll
        for (int m = 0; m < 4; ++m) {
            const int pp = i * 128 + wm * 64 + m * 16 + fr;
            if (pp < cnt) {
                const int tok = list[c * T_TOK + pp];
                const float gw = tokw[(long)tok * 2 + es];
                half_t* dst = act + ((long)mm.moff[c] * 128 + pp) * 512 + es * 256 + fb * 32;
#pragma unroll
                for (int n = 0; n < 2; ++n) {
                    const f4 g = acc[m][n], uu = acc[m][n + 2];
                    store_h4(dst + n * 16 + 4 * fq, siluf_(g[0]) * uu[0] * gw, siluf_(g[1]) * uu[1] * gw, siluf_(g[2]) * uu[2] * gw, siluf_(g[3]) * uu[3] * gw);
                }
            }
        }
    }
}

__device__ __forceinline__ void phase6b(const Params& p, char* lds, int bid, int nb) {
    __shared__ MoeMap mm;
    moe_map_build(p, &mm);
    const int tid = threadIdx.x, wid = tid >> 6, lane = tid & 63, wm = wid >> 2, wn = wid & 3, fr = lane & 15, fq = lane >> 4;
    const half_t* wed = (const half_t*)(p.ws + OFF_GQKV) + 16l * 512 * 1024;
    const int* list = (const int*)(p.ws + OFF_LIST);
    const half_t* act = (const half_t*)(p.ws + OFF_QKV);
    float* ybuf = (float*)(p.ws + OFF_RB);
    const int total = mm.moff[24] * 4;
    for (int u = bid; u < total; u += nb) {
        const int mtg = u >> 2, nt = u & 3;
        int c = 0;
#pragma unroll 1
        for (int cc = 1; cc < 24; ++cc) if (mm.moff[cc] <= mtg) c = cc;
        const int i = mtg - mm.moff[c], cnt = mm.cnt[c];
        int elo, ehi; cls_experts(c, elo, ehi);
        f4 acc[4][4]; zero_acc(acc);
        const half_t* arow = act + ((long)mm.moff[c] * 128 + i * 128) * 512;
        gemm_accum<2, 4>(lds, 256, RowLoad{arow, 512}, RowLoad{wed + ((long)elo * 1024 + nt * 256) * 256, 256}, acc);
        gemm_accum<2, 4>(lds, 256, RowLoad{arow + 256, 512}, RowLoad{wed + ((long)ehi * 1024 + nt * 256) * 256, 256}, acc);
#pragma unroll
        for (int m = 0; m < 4; ++m) {
            const int pp = i * 128 + wm * 64 + m * 16 + fr;
            if (pp < cnt) {
                const long tok = list[c * T_TOK + pp];
#pragma unroll
                for (int n = 0; n < 4; ++n) *(f4*)(ybuf + tok * 1024 + nt * 256 + wn * 64 + n * 16 + 4 * fq) = acc[m][n];
            }
        }
    }
}

__device__ __forceinline__ void phase6c(const Params& p, int bid, int nb) {
    const int wid = threadIdx.x >> 6, lane = threadIdx.x & 63;
    const float* ybuf = (const float*)(p.ws + OFF_RB);
    for (int u = bid; u < T_TOK / 8; u += nb) {
        const int t = u * 8 + wid, b = t >> 12;
        const float* mod = (const float*)(p.ws + OFF_MOD) + b * 6144;
        f4 y[4]; float ss = 0.f;
#pragma unroll
        for (int i = 0; i < 4; ++i) { y[i] = *(const f4*)(ybuf + (long)t * 1024 + i * 256 + lane * 4); ss += y[i][0] * y[i][0] + y[i][1] * y[i][1] + y[i][2] * y[i][2] + y[i][3] * y[i][3]; }
        ss = wave_sum(ss);
        const float r = rsqrtf(ss * (1.0f / DM) + 1e-6f);
#pragma unroll
        for (int i = 0; i < 4; ++i) {
            const int c = i * 256 + lane * 4;
            const f4 x1 = *(const f4*)(p.out + (long)t * 1024 + c), w = *(const f4*)(p.norm_post2 + c), g2 = *(const f4*)(mod + 5120 + c);
            f4 o;
#pragma unroll
            for (int j = 0; j < 4; ++j) o[j] = x1[j] + g2[j] * (y[i][j] * r * w[j]);
            *(f4*)(p.out + (long)t * 1024 + c) = o;
        }
    }
}

template <int PH>
__global__ void __launch_bounds__(NTHREADS) phase_kernel(Params p) {
    __shared__ __attribute__((aligned(16))) char smem[LDS_BYTES];
    const int bid = blockIdx.x, nb = gridDim.x;
    if (PH == 0) phase0(p, smem, bid, nb);
    if (PH == 1) phase1(p, bid, nb);
    if (PH == 2) phase2(p, smem, bid, nb);
    if (PH == 3) phase3(p, smem, bid, nb);
    if (PH == 4) phase4(p, smem, bid, nb);
    if (PH == 5) phase5a(p, smem, bid, nb);
    if (PH == 6) phase5b(p, smem, bid, nb);
    if (PH == 7) phase5c(p, smem, bid, nb);
    if (PH == 8) phase6a(p, smem, bid, nb);
    if (PH == 9) phase6b(p, smem, bid, nb);
    if (PH == 10) phase6c(p, bid, nb);
}

extern "C" void kernel_launch(void* const* d_in, const int* in_sizes, int n_in, void* d_out, int out_size, void* d_ws, size_t ws_size, hipStream_t stream) {
    if (ws_size < WS_NEEDED) return;
    Params p{};
    p.x = (const float*)d_in[0]; p.c = (const float*)d_in[1]; p.pos = (const int*)d_in[2]; p.w_ada = (const float*)d_in[3]; p.b_ada = (const float*)d_in[4];
    p.norm_pre1 = (const float*)d_in[5]; p.norm_post1 = (const float*)d_in[6]; p.w_in = (const float*)d_in[7]; p.conv_w = (const float*)d_in[8];
    p.a_log = (const float*)d_in[9]; p.dt_bias = (const float*)d_in[10]; p.gdn_norm = (const float*)d_in[11]; p.w_bd = (const float*)d_in[12]; p.w_bg = (const float*)d_in[13];
    p.w_out = (const float*)d_in[14]; p.norm_pre2 = (const float*)d_in[15]; p.norm_post2 = (const float*)d_in[16]; p.w_rg = (const float*)d_in[17]; p.b_rg = (const float*)d_in[18];
    p.w_re = (const float*)d_in[19]; p.b_re = (const float*)d_in[20]; p.w_eg = (const float*)d_in[21]; p.w_eu = (const float*)d_in[22]; p.w_ed = (const float*)d_in[23];
    p.out = (float*)d_out; p.ws = (char*)d_ws;
    const int G = 256;
    phase_kernel<0><<<G, NTHREADS, 0, stream>>>(p);
    phase_kernel<1><<<G, NTHREADS, 0, stream>>>(p);
    phase_kernel<2><<<G, NTHREADS, 0, stream>>>(p);
    phase_kernel<3><<<G, NTHREADS, 0, stream>>>(p);
    phase_kernel<4><<<G, NTHREADS, 0, stream>>>(p);
    phase_kernel<5><<<G, NTHREADS, 0, stream>>>(p);
    phase_kernel<6><<<G, NTHREADS, 0, stream>>>(p);
    phase_kernel<7><<<G, NTHREADS, 0, stream>>>(p);
    phase_kernel<8><<<G, NTHREADS, 0, stream>>>(p);
    phase_kernel<9><<<G, NTHREADS, 0, stream>>>(p);
    phase_kernel<10><<<G, NTHREADS, 0, stream>>>(p);
}
```
